# Optimizing an MI355X kernel written in HIP

```python
import jax, jax.numpy as jnp
from jax import lax
import numpy as np

D_MODEL = 1024
BATCH = 4
SEQ = 8192
DEPTH = 2

A_WIDTH = D_MODEL // 2
A_HEADS = 8
CONV_WIDTH = 3
B_WIDTH = D_MODEL // 2
POOL_WINDOWS = (2, 4, 8, 16)
B_GROUPS = len(POOL_WINDOWS)
B_GROUP_DIM = B_WIDTH // B_GROUPS
EVEN_IN = 4 * A_WIDTH + 2 * B_WIDTH
EVEN_MIX = A_WIDTH + B_WIDTH
C_WIDTH = D_MODEL
C_HEADS = 8
C_HEAD_DIM = C_WIDTH // C_HEADS
CHUNK = 128
ODD_IN = 3 * C_WIDTH
N_EVEN = (DEPTH + 1) // 2
N_ODD = DEPTH // 2
EPS = 1e-6

kernel_name = "hybrid_conv_pool_gmlp_trunk"


def rmsnorm(x, g):
    xf = x.astype(jnp.float32)
    y = xf * lax.rsqrt(jnp.mean(xf * xf, axis=-1, keepdims=True) + EPS)
    return (y * g.astype(jnp.float32)).astype(x.dtype)


def layernorm(x, g, b):
    xf = x.astype(jnp.float32)
    mu = jnp.mean(xf, axis=-1, keepdims=True)
    var = jnp.mean(jnp.square(xf - mu), axis=-1, keepdims=True)
    y = (xf - mu) * lax.rsqrt(var + EPS)
    return (y * g.astype(jnp.float32) + b.astype(jnp.float32)).astype(x.dtype)


def short_gated_conv(xa, gb, gc, conv_w):
    S = xa.shape[1]
    h = gc * xa
    hp = jnp.pad(h, ((0, 0), (CONV_WIDTH - 1, 0), (0, 0)))
    conv = sum(conv_w[k] * hp[:, k:k + S] for k in range(CONV_WIDTH))
    return gb * conv


def multiscale_pool(xp, pool_w, pool_scale):
    Bsz, S, _ = xp.shape
    xf = xp.astype(jnp.float32)
    cs = jnp.cumsum(xf, axis=1)
    pos = jnp.arange(S)
    outs = []
    for g, w in enumerate(POOL_WINDOWS):
        sl = slice(g * B_GROUP_DIM, (g + 1) * B_GROUP_DIM)
        cs_g = cs[..., sl]
        lower = jnp.pad(cs_g, ((0, 0), (w, 0), (0, 0)))[:, :S]
        count = jnp.minimum(pos + 1, w).astype(jnp.float32)[None, :, None]
        outs.append((cs_g - lower) / count - xf[..., sl])
    pooled = jnp.stack(outs, axis=2).astype(xp.dtype)
    mixed = jnp.einsum('bsgc,gcd->bsgd', pooled, pool_w)
    return mixed.reshape(Bsz, S, B_WIDTH) * pool_scale


def even_layer(h, w_in, conv_w, pool_w, pool_scale, w_out):
    proj = h @ w_in
    xa, gb, gc, za, xp, zp = jnp.split(
        proj, np.cumsum([A_WIDTH] * 4 + [B_WIDTH]).tolist(), axis=-1)
    ya = short_gated_conv(xa, gb, gc, conv_w) * jax.nn.silu(za)
    yb = multiscale_pool(xp, pool_w, pool_scale) * jax.nn.silu(zp)
    return jnp.concatenate([ya, yb], axis=-1) @ w_out


def odd_layer(h, w_in, ln_g, ln_b, w_s, b_s, w_out):
    Bsz, S, _ = h.shape
    proj = h @ w_in
    u, v, z = jnp.split(proj, 3, axis=-1)
    v = layernorm(v, ln_g, ln_b)
    vc = v.reshape(Bsz, S // CHUNK, CHUNK, C_HEADS, C_HEAD_DIM)
    ws = jnp.tril(w_s)
    sv = jnp.einsum('hts,bnshc->bnthc', ws, vc) + b_s.T[None, None, :, :, None]
    y = u * sv.reshape(Bsz, S, C_WIDTH) * jax.nn.silu(z)
    return y @ w_out


def setup_inputs(seed: int = 0) -> dict:
    key = jax.random.key(seed)
    ks = jax.random.split(key, 16)
    f32 = jnp.float32
    nrm = lambda k, shape, s: jax.random.normal(k, shape, f32) * s
    return {
        "x": nrm(ks[0], (BATCH, SEQ, D_MODEL), 1.0),
        "pre_norm": 1.0 + nrm(ks[1], (DEPTH, D_MODEL), 0.05),
        "post_norm": 1.0 + nrm(ks[2], (DEPTH, D_MODEL), 0.05),
        "even_w_in": nrm(ks[3], (N_EVEN, D_MODEL, EVEN_IN), D_MODEL ** -0.5),
        "even_conv_w": nrm(ks[4], (N_EVEN, CONV_WIDTH, A_WIDTH), CONV_WIDTH ** -0.5),
        "even_pool_w": nrm(ks[5], (N_EVEN, B_GROUPS, B_GROUP_DIM, B_GROUP_DIM), B_GROUP_DIM ** -0.5),
        "even_pool_scale": 1.0 + nrm(ks[6], (N_EVEN, B_WIDTH), 0.1),
        "even_w_out": nrm(ks[7], (N_EVEN, EVEN_MIX, D_MODEL), EVEN_MIX ** -0.5),
        "odd_w_in": nrm(ks[8], (N_ODD, D_MODEL, ODD_IN), D_MODEL ** -0.5),
        "odd_ln_g": 1.0 + nrm(ks[9], (N_ODD, C_WIDTH), 0.05),
        "odd_ln_b": nrm(ks[10], (N_ODD, C_WIDTH), 0.02),
        "odd_w_s": nrm(ks[11], (N_ODD, C_HEADS, CHUNK, CHUNK), CHUNK ** -0.5),
        "odd_b_s": 1.0 + nrm(ks[12], (N_ODD, C_HEADS, CHUNK), 0.1),
        "odd_w_out": nrm(ks[13], (N_ODD, C_WIDTH, D_MODEL), C_WIDTH ** -0.5),
    }


def reference(x, pre_norm, post_norm, even_w_in, even_conv_w, even_pool_w,
              even_pool_scale, even_w_out, odd_w_in, odd_ln_g, odd_ln_b,
              odd_w_s, odd_b_s, odd_w_out):
    for i in range(DEPTH):
        h = rmsnorm(x, pre_norm[i])
        j = i // 2
        if i % 2 == 0:
            m = even_layer(h, even_w_in[j], even_conv_w[j], even_pool_w[j],
                           even_pool_scale[j], even_w_out[j])
        else:
            m = odd_layer(h, odd_w_in[j], odd_ln_g[j], odd_ln_b[j],
                          odd_w_s[j], odd_b_s[j], odd_w_out[j])
        x = x + rmsnorm(m, post_norm[i])
    return x
```

```cpp
#include <hip/hip_runtime.h>
#include <hip/hip_bf16.h>
#include <cstdint>

constexpr int D = 1024, BATCH = 4, SEQ = 8192, M = BATCH * SEQ, NIN = 3072;
constexpr float EPS = 1e-6f;
typedef unsigned short bf16_t;
__device__ __forceinline__ float bf2f(bf16_t b) { return __uint_as_float(((unsigned)b) << 16); }
__device__ __forceinline__ bf16_t f2bf(float f) { unsigned u = __float_as_uint(f); return (bf16_t)((u + 0x7fffu + ((u >> 16) & 1u)) >> 16); }
__device__ __forceinline__ float silu(float z) { return z / (1.f + __expf(-z)); }

__device__ __forceinline__ float block_sum(float v, float* red) {
    for (int o = 32; o >= 1; o >>= 1) v += __shfl_xor(v, o);
    __syncthreads();
    if ((threadIdx.x & 63) == 0) red[threadIdx.x >> 6] = v;
    __syncthreads();
    float s = 0.f; for (int i = 0; i < (int)(blockDim.x >> 6); ++i) s += red[i];
    return s;
}
__global__ void k_rmsnorm(const float* x, const float* g, float* h) {
    __shared__ float red[8];
    const size_t r = blockIdx.x; float v[4]; float s = 0.f;
    for (int j = 0; j < 4; ++j) { v[j] = x[r * D + threadIdx.x + 256 * j]; s += v[j] * v[j]; }
    const float rstd = rsqrtf(block_sum(s, red) / D + EPS);
    for (int j = 0; j < 4; ++j) h[r * D + threadIdx.x + 256 * j] = v[j] * rstd * g[threadIdx.x + 256 * j];
}
__global__ void k_post(const float* xin, const float* m, const float* g, float* xout) {
    __shared__ float red[8];
    const size_t r = blockIdx.x; float v[4]; float s = 0.f;
    for (int j = 0; j < 4; ++j) { v[j] = m[r * D + threadIdx.x + 256 * j]; s += v[j] * v[j]; }
    const float rstd = rsqrtf(block_sum(s, red) / D + EPS);
    for (int j = 0; j < 4; ++j) { const size_t i = r * D + threadIdx.x + 256 * j; xout[i] = xin[i] + v[j] * rstd * g[threadIdx.x + 256 * j]; }
}
template <bool OUT_BF16>
__global__ void k_gemm(const float* A, const float* B, void* Cv, int N, int K) {
    __shared__ float As[16][65], Bs[16][65];
    const int tx = threadIdx.x & 15, ty = threadIdx.x >> 4, m0 = blockIdx.y * 64, n0 = blockIdx.x * 64;
    float acc[4][4] = {};
    for (int k0 = 0; k0 < K; k0 += 16) {
        for (int i = threadIdx.x; i < 1024; i += 256) { const int r = i >> 4, c = i & 15; As[c][r] = A[(size_t)(m0 + r) * K + k0 + c]; }
        for (int i = threadIdx.x; i < 1024; i += 256) { const int r = i >> 6, c = i & 63; Bs[r][c] = B[(size_t)(k0 + r) * N + n0 + c]; }
        __syncthreads();
#pragma unroll
        for (int k = 0; k < 16; ++k) {
            float a[4], b[4];
#pragma unroll
            for (int i = 0; i < 4; ++i) { a[i] = As[k][ty * 4 + i]; b[i] = Bs[k][tx * 4 + i]; }
#pragma unroll
            for (int i = 0; i < 4; ++i)
#pragma unroll
                for (int j = 0; j < 4; ++j) acc[i][j] += a[i] * b[j];
        }
        __syncthreads();
    }
    for (int i = 0; i < 4; ++i) for (int j = 0; j < 4; ++j) {
        const size_t o = (size_t)(m0 + ty * 4 + i) * N + n0 + tx * 4 + j;
        if (OUT_BF16) ((bf16_t*)Cv)[o] = f2bf(acc[i][j]); else ((float*)Cv)[o] = acc[i][j];
    }
}
__global__ void k_mix0(const bf16_t* proj, const float* conv_w, float* Y, float* P) {
    const size_t idx = (size_t)blockIdx.x * 256 + threadIdx.x; const int c = idx & 511; const size_t r = idx >> 9; const int t = (int)(r % SEQ);
    const bf16_t* p = proj + r * NIN;
    float conv = 0.f;
    for (int k = 0; k < 3; ++k) { const int dt = 2 - k; if (t - dt >= 0) { const bf16_t* q = p - (size_t)dt * NIN; conv += conv_w[k * 512 + c] * bf2f(q[1024 + c]) * bf2f(q[c]); } }
    Y[r * D + c] = bf2f(p[512 + c]) * conv * silu(bf2f(p[1536 + c]));
    const int g = c >> 7, w = 2 << g; float s = 0.f; int cnt = 0;
    for (int j = 0; j < w; ++j) if (t - j >= 0) { s += bf2f((p - (size_t)j * NIN)[2048 + c]); ++cnt; }
    P[r * 512 + c] = s / (float)cnt - bf2f(p[2048 + c]);
}
__global__ void k_pool(const float* P, const float* pool_w, const float* scale, const bf16_t* proj, float* Y) {
    const size_t idx = (size_t)blockIdx.x * 256 + threadIdx.x; const int dd = idx & 511; const size_t r = idx >> 9; const int g = dd >> 7, d = dd & 127;
    float s = 0.f; const float* pr = P + r * 512 + g * 128; const float* w = pool_w + (size_t)g * 128 * 128 + d;
    for (int c = 0; c < 128; ++c) s += pr[c] * w[c * 128];
    Y[r * D + 512 + dd] = s * scale[dd] * silu(bf2f(proj[r * NIN + 2560 + dd]));
}
__global__ void k_ln(const bf16_t* proj, const float* g, const float* b, float* V) {
    __shared__ float red[8];
    const size_t r = blockIdx.x; float v[4]; float s = 0.f;
    for (int j = 0; j < 4; ++j) { v[j] = bf2f(proj[r * NIN + 1024 + threadIdx.x + 256 * j]); s += v[j]; }
    const float mu = block_sum(s, red) / D; float q = 0.f;
    for (int j = 0; j < 4; ++j) { v[j] -= mu; q += v[j] * v[j]; }
    const float rstd = rsqrtf(block_sum(q, red) / D + EPS);
    for (int j = 0; j < 4; ++j) { const int c = threadIdx.x + 256 * j; V[r * D + c] = v[j] * rstd * g[c] + b[c]; }
}
__global__ void k_mix1(const bf16_t* proj, const float* V, const float* w_s, const float* b_s, float* Y) {
    const size_t idx = (size_t)blockIdx.x * 256 + threadIdx.x; const int c = idx & 1023; const size_t r = idx >> 10; const int t = (int)(r & 127), h = c >> 7; const size_t r0 = r - t;
    const float* w = w_s + ((size_t)h * 128 + t) * 128; float s = 0.f;
    for (int j = 0; j <= t; ++j) s += w[j] * V[(r0 + j) * D + c];
    s += b_s[h * 128 + t];
    Y[r * D + c] = bf2f(proj[r * NIN + c]) * s * silu(bf2f(proj[r * NIN + 2048 + c]));
}

extern "C" void kernel_launch(void* const* d_in, const int* in_sizes, int n_in, void* d_out, int out_size, void* d_ws, size_t ws_size, hipStream_t stream) {
    const float* x = (const float*)d_in[0]; const float* pre = (const float*)d_in[1]; const float* post = (const float*)d_in[2];
    const float* e_win = (const float*)d_in[3]; const float* e_conv = (const float*)d_in[4]; const float* e_pw = (const float*)d_in[5]; const float* e_ps = (const float*)d_in[6]; const float* e_wout = (const float*)d_in[7];
    const float* o_win = (const float*)d_in[8]; const float* o_g = (const float*)d_in[9]; const float* o_b = (const float*)d_in[10]; const float* o_ws = (const float*)d_in[11]; const float* o_bs = (const float*)d_in[12]; const float* o_wout = (const float*)d_in[13];
    float* out = (float*)d_out; char* ws = (char*)d_ws;
    float* bufA = (float*)ws; bf16_t* proj = (bf16_t*)(ws + (size_t)M * D * 4); float* bufM = (float*)(ws + (size_t)M * D * 4 + (size_t)M * NIN * 2);
    k_rmsnorm<<<M, 256, 0, stream>>>(x, pre, bufA);
    k_gemm<true><<<dim3(NIN / 64, M / 64), 256, 0, stream>>>(bufA, e_win, proj, NIN, D);
    k_mix0<<<M * 512 / 256, 256, 0, stream>>>(proj, e_conv, bufA, bufM);
    k_pool<<<M * 512 / 256, 256, 0, stream>>>(bufM, e_pw, e_ps, proj, bufA);
    k_gemm<false><<<dim3(D / 64, M / 64), 256, 0, stream>>>(bufA, e_wout, bufM, D, D);
    k_post<<<M, 256, 0, stream>>>(x, bufM, post, out);
    k_rmsnorm<<<M, 256, 0, stream>>>(out, pre + D, bufA);
    k_gemm<true><<<dim3(NIN / 64, M / 64), 256, 0, stream>>>(bufA, o_win, proj, NIN, D);
    k_ln<<<M, 256, 0, stream>>>(proj, o_g, o_b, bufM);
    k_mix1<<<M * 1024 / 256, 256, 0, stream>>>(proj, bufM, o_ws, o_bs, bufA);
    k_gemm<false><<<dim3(D / 64, M / 64), 256, 0, stream>>>(bufA, o_wout, bufM, D, D);
    k_post<<<M, 256, 0, stream>>>(out, bufM, post + D, out);
}
```
